# Optimizing an MI355X kernel written in HIP

```python
import jax, jax.numpy as jnp
from jax import lax
import numpy as np

D_MODEL = 1024
BATCH = 2
SEQ = 8192
DEPTH = 2

GRID_W = 64
POOL_W = D_MODEL // 4
N_POOL_GROUPS = 4
POOL_GROUP_W = POOL_W // N_POOL_GROUPS
POOL_WINDOWS = (2, 4, 8, 16)
NA_HEAD_DIM = 64
NA_W = D_MODEL // 2
NA_HEADS = NA_W // NA_HEAD_DIM
NA_ROWS = 8
NA_COLS = 16
NA_QR = 2
NA_QC = 16
CONV_W = D_MODEL // 4
CONV_K = 31
D_MIX = POOL_W + NA_W + CONV_W
OFF_POOL = 0
OFF_Q = OFF_POOL + POOL_W
OFF_K = OFF_Q + NA_W
OFF_V = OFF_K + NA_W
OFF_CA = OFF_V + NA_W
OFF_CG = OFF_CA + CONV_W
D_IN = OFF_CG + CONV_W
N_EXPERTS = 32
TOP_K = 4
D_FF = D_MODEL
SWIGLU_ALPHA = 1.702
SWIGLU_LIMIT = 7.0
DEEPNORM_ALPHA = (2.0 * DEPTH) ** 0.25
DEEPNORM_BETA = (8.0 * DEPTH) ** -0.25
LN_EPS = 1e-5
NEG_INF = -1e30

kernel_name = "hybrid_pool_natten_conformer_moe_deepnorm"


def _layer_norm(x, g, b):
    xf = x.astype(jnp.float32)
    mu = jnp.mean(xf, axis=-1, keepdims=True)
    var = jnp.mean(jnp.square(xf - mu), axis=-1, keepdims=True)
    y = (xf - mu) * lax.rsqrt(var + LN_EPS)
    return (y * g + b).astype(x.dtype)


def _pool_mixer(u, w_pool, scale):
    B, S, C = u.shape
    uf = u.astype(jnp.float32)
    cs = jnp.concatenate([jnp.zeros((B, 1, C), jnp.float32), jnp.cumsum(uf, axis=1)], axis=1)
    t = np.arange(S)
    outs = []
    for g, w in enumerate(POOL_WINDOWS):
        sl = slice(g * POOL_GROUP_W, (g + 1) * POOL_GROUP_W)
        lo = np.clip(t - w // 2, 0, S)
        hi = np.clip(t + w // 2, 0, S)
        cnt = (hi - lo).astype(np.float32)
        mean = (cs[:, hi, sl] - cs[:, lo, sl]) / cnt[None, :, None]
        d = (mean - uf[..., sl]).astype(u.dtype)
        outs.append(jnp.einsum('bsc,cd->bsd', d, w_pool[g]))
    return jnp.concatenate(outs, axis=-1) * scale


def _na_tables(rows):
    kr = min(NA_ROWS, rows)
    band_r = min(rows, kr + NA_QR - 1)
    band_c = min(GRID_W, NA_COLS + NA_QC - 1)
    r0 = np.arange(0, rows, NA_QR)
    c0 = np.arange(0, GRID_W, NA_QC)
    br = np.clip(r0 - kr // 2, 0, rows - band_r)
    bc = np.clip(c0 - NA_COLS // 2, 0, GRID_W - band_c)
    qr, qc = np.broadcast_arrays(r0[:, None, None, None] + np.arange(NA_QR)[None, None, :, None],
                                 c0[None, :, None, None] + np.arange(NA_QC)[None, None, None, :])
    qr = qr.reshape(-1, NA_QR * NA_QC)
    qc = qc.reshape(-1, NA_QR * NA_QC)
    kr_, kc_ = np.broadcast_arrays(br[:, None, None, None] + np.arange(band_r)[None, None, :, None],
                                   bc[None, :, None, None] + np.arange(band_c)[None, None, None, :])
    kr_ = kr_.reshape(-1, band_r * band_c)
    kc_ = kc_.reshape(-1, band_r * band_c)
    sr = np.clip(qr - kr // 2, 0, rows - kr)[..., None]
    sc = np.clip(qc - NA_COLS // 2, 0, GRID_W - NA_COLS)[..., None]
    krk = kr_[:, None, :]
    kck = kc_[:, None, :]
    mask = (krk >= sr) & (krk < sr + kr) & (kck >= sc) & (kck < sc + NA_COLS)
    r_off = np.clip(krk - qr[..., None] + NA_ROWS - 1, 0, 2 * NA_ROWS - 2)
    c_off = np.clip(kck - qc[..., None] + NA_COLS - 1, 0, 2 * NA_COLS - 2)
    q_idx = qr * GRID_W + qc
    k_idx = kr_ * GRID_W + kc_
    inv = np.argsort(q_idx.reshape(-1))
    return q_idx, k_idx, r_off, c_off, mask, inv


def _neighbourhood_attention(q, k, v, rpb):
    B, S, H, Dh = q.shape
    rows = S // GRID_W
    q_idx, k_idx, r_off, c_off, mask, inv = _na_tables(rows)
    qb = jnp.take(q, q_idx, axis=1)
    kb = jnp.take(k, k_idx, axis=1)
    vb = jnp.take(v, k_idx, axis=1)
    bias = jnp.where(mask, rpb[:, r_off, c_off].astype(jnp.float32), NEG_INF)
    s = jnp.einsum('bnqhd,bnkhd->bhnqk', qb, kb).astype(jnp.float32) * (Dh ** -0.5) + bias
    p = jax.nn.softmax(s, axis=-1).astype(v.dtype)
    o = jnp.einsum('bhnqk,bnkhd->bnqhd', p, vb).reshape(B, S, H * Dh)
    return jnp.take(o, inv, axis=1)


def _conv_module(a, gate, w_dw, b_dw, ln_g, ln_b, w_pw, b_pw):
    h = a * jax.nn.sigmoid(gate)
    h = lax.conv_general_dilated(h, w_dw, window_strides=(1,),
                                 padding=[(CONV_K // 2, CONV_K // 2)],
                                 dimension_numbers=('NWC', 'WIO', 'NWC'),
                                 feature_group_count=h.shape[-1]) + b_dw
    h = jax.nn.silu(_layer_norm(h, ln_g, ln_b))
    return h @ w_pw + b_pw


def _moe(h, w_router, b_router, w_gate, b_gate, w_up, b_up, w_down, b_down):
    B, S, D = h.shape
    hf = h.reshape(-1, D)
    logits = (hf @ w_router + b_router).astype(jnp.float32)
    top_v, top_i = lax.top_k(logits, TOP_K)
    probs = jax.nn.softmax(top_v, axis=-1)
    gates = jnp.sum(jax.nn.one_hot(top_i, N_EXPERTS, dtype=jnp.float32) * probs[..., None], axis=1).astype(h.dtype)
    out = jnp.zeros_like(hf)
    for e in range(N_EXPERTS):
        g = jnp.minimum(hf @ w_gate[e] + b_gate[e], SWIGLU_LIMIT)
        u = jnp.clip(hf @ w_up[e] + b_up[e], -SWIGLU_LIMIT, SWIGLU_LIMIT)
        act = (u + 1.0) * g * jax.nn.sigmoid(SWIGLU_ALPHA * g)
        out = out + gates[:, e:e + 1] * (act @ w_down[e] + b_down[e])
    return out.reshape(B, S, D)


def setup_inputs(seed: int = 0) -> dict:
    key = jax.random.key(seed)
    ks = jax.random.split(key, 26)

    def nrm(k, shape, scale):
        return jax.random.normal(k, shape, jnp.float32) * scale

    col_scale = np.ones((D_IN,), np.float32)
    col_scale[OFF_V:OFF_V + NA_W] = DEEPNORM_BETA
    return {
        "x": nrm(ks[0], (BATCH, SEQ, D_MODEL), 1.0),
        "w_in": nrm(ks[1], (DEPTH, D_MODEL, D_IN), D_MODEL ** -0.5) * jnp.asarray(col_scale),
        "b_in": nrm(ks[2], (DEPTH, D_IN), 0.02),
        "w_pool": nrm(ks[3], (DEPTH, N_POOL_GROUPS, POOL_GROUP_W, POOL_GROUP_W), POOL_GROUP_W ** -0.5),
        "pool_scale": 1.0 + nrm(ks[4], (DEPTH, POOL_W), 0.02),
        "rpb": nrm(ks[5], (DEPTH, NA_HEADS, 2 * NA_ROWS - 1, 2 * NA_COLS - 1), 0.1),
        "conv_dw": nrm(ks[6], (DEPTH, CONV_K, 1, CONV_W), CONV_K ** -0.5),
        "conv_dw_b": nrm(ks[7], (DEPTH, CONV_W), 0.02),
        "conv_ln_g": 1.0 + nrm(ks[8], (DEPTH, CONV_W), 0.02),
        "conv_ln_b": nrm(ks[9], (DEPTH, CONV_W), 0.02),
        "w_conv_pw": nrm(ks[10], (DEPTH, CONV_W, CONV_W), CONV_W ** -0.5),
        "b_conv_pw": nrm(ks[11], (DEPTH, CONV_W), 0.02),
        "w_out": nrm(ks[12], (DEPTH, D_MIX, D_MODEL), (D_MIX ** -0.5) * DEEPNORM_BETA),
        "b_out": nrm(ks[13], (DEPTH, D_MODEL), 0.02),
        "ln1_g": 1.0 + nrm(ks[14], (DEPTH, D_MODEL), 0.02),
        "ln1_b": nrm(ks[15], (DEPTH, D_MODEL), 0.02),
        "w_router": nrm(ks[16], (DEPTH, D_MODEL, N_EXPERTS), D_MODEL ** -0.5),
        "b_router": nrm(ks[17], (DEPTH, N_EXPERTS), 0.01),
        "w_gate": nrm(ks[18], (DEPTH, N_EXPERTS, D_MODEL, D_FF), D_MODEL ** -0.5),
        "b_gate": nrm(ks[19], (DEPTH, N_EXPERTS, D_FF), 0.02),
        "w_up": nrm(ks[20], (DEPTH, N_EXPERTS, D_MODEL, D_FF), D_MODEL ** -0.5),
        "b_up": nrm(ks[21], (DEPTH, N_EXPERTS, D_FF), 0.02),
        "w_down": nrm(ks[22], (DEPTH, N_EXPERTS, D_FF, D_MODEL), (D_FF ** -0.5) * DEEPNORM_BETA),
        "b_down": nrm(ks[23], (DEPTH, N_EXPERTS, D_MODEL), 0.02),
        "ln2_g": 1.0 + nrm(ks[24], (DEPTH, D_MODEL), 0.02),
        "ln2_b": nrm(ks[25], (DEPTH, D_MODEL), 0.02),
    }


def reference(x, w_in, b_in, w_pool, pool_scale, rpb, conv_dw, conv_dw_b, conv_ln_g, conv_ln_b,
              w_conv_pw, b_conv_pw, w_out, b_out, ln1_g, ln1_b, w_router, b_router,
              w_gate, b_gate, w_up, b_up, w_down, b_down, ln2_g, ln2_b):
    B, S, _ = x.shape
    for l in range(DEPTH):
        z = x @ w_in[l] + b_in[l]
        q = z[..., OFF_Q:OFF_K].reshape(B, S, NA_HEADS, NA_HEAD_DIM)
        k = z[..., OFF_K:OFF_V].reshape(B, S, NA_HEADS, NA_HEAD_DIM)
        v = z[..., OFF_V:OFF_CA].reshape(B, S, NA_HEADS, NA_HEAD_DIM)
        y_pool = _pool_mixer(z[..., OFF_POOL:OFF_Q], w_pool[l], pool_scale[l])
        y_attn = _neighbourhood_attention(q, k, v, rpb[l])
        y_conv = _conv_module(z[..., OFF_CA:OFF_CG], z[..., OFF_CG:D_IN], conv_dw[l], conv_dw_b[l],
                              conv_ln_g[l], conv_ln_b[l], w_conv_pw[l], b_conv_pw[l])
        mix = jnp.concatenate([y_pool, y_attn, y_conv], axis=-1) @ w_out[l] + b_out[l]
        x = _layer_norm(DEEPNORM_ALPHA * x + mix, ln1_g[l], ln1_b[l])
        ffn = _moe(x, w_router[l], b_router[l], w_gate[l], b_gate[l], w_up[l], b_up[l], w_down[l], b_down[l])
        x = _layer_norm(DEEPNORM_ALPHA * x + ffn, ln2_g[l], ln2_b[l])
    return x
```

```cpp
#include <hip/hip_runtime.h>
#include <cstdio>
#include <cstdint>

#ifndef ONE_LAUNCH
#define ONE_LAUNCH 0
#endif

#define LAS __attribute__((address_space(3)))

constexpr int NTOK = 16384, S = 8192, D = 1024, DIN = 2304;
constexpr int OFF_POOL = 0, OFF_Q = 256, OFF_K = 768, OFF_V = 1280, OFF_CA = 1792, OFF_CG = 2048;
constexpr int NE = 32, CONVK = 31, CW = 256;
constexpr float ALPHA = 1.41421356237309515f;
constexpr float LN_EPS = 1e-5f;
constexpr int NTHR = 512, NWAVES = 8;
constexpr int LDS_BYTES = 147456;

constexpr size_t MiB = 1u << 20;
constexpr size_t WS_CTL = 0, CTL_BYTES = 1 * MiB;
constexpr size_t WS_LIST = 1 * MiB;
constexpr size_t WS_TINFO = 3 * MiB;
constexpr size_t WS_TPROB = 4 * MiB;
constexpr size_t WS_HC = 8 * MiB;
constexpr size_t WS_Z = 24 * MiB;
constexpr size_t WS_CAT = 168 * MiB;
constexpr size_t WS_X1 = 232 * MiB;
constexpr size_t WS_XC = 296 * MiB;
constexpr size_t WS_H = 360 * MiB;
constexpr size_t WS_Y = 616 * MiB;
constexpr size_t WS_END = 872 * MiB;
constexpr int CW_CNT = 64;
constexpr int CW_BAR = 4096;

#define XB_TMO      128
#define XB_XCNT(j)  (256  + 64 * (j))
#define XB_XSUB(j)  (1280 + 64 * (j))
#define XB_XGEN(j)  (2304 + 64 * (j))
#define XB_TOP      3328
#define XB_TOPGEN   3392
#define XCD_BAR_WORDS 3456
#define XB_SPIN_CAP (1u << 18)

__device__ __forceinline__ unsigned xb_ld(unsigned* p)              { return __hip_atomic_load(p, __ATOMIC_RELAXED, __HIP_MEMORY_SCOPE_AGENT); }
__device__ __forceinline__ unsigned xb_add(unsigned* p, unsigned v) { return __hip_atomic_fetch_add(p, v, __ATOMIC_RELAXED, __HIP_MEMORY_SCOPE_AGENT); }
__device__ __forceinline__ unsigned xb_xcc_id() { return (unsigned)__builtin_amdgcn_s_getreg((3 << 11) | 20) & 0xFu; }
#define XB_SPIN(cond, bar) do { unsigned _sp = 0; while (cond) { __builtin_amdgcn_s_sleep(1); \
    if ((++_sp & 255u) == 0u) { if (xb_ld(&(bar)[XB_TMO])) break; if (_sp > XB_SPIN_CAP) { atomicAdd(&(bar)[XB_TMO], 1u); break; } } } } while (0)

struct XcdBarrier { unsigned* bar; unsigned x; volatile LAS unsigned* st; };

__device__ __forceinline__ XcdBarrier xcd_barrier_post(unsigned* bar, volatile LAS unsigned* st) {
    XcdBarrier b; b.bar = bar; b.x = xb_xcc_id(); b.st = st;
    if (threadIdx.x == 0) (void)xb_add(&bar[XB_XCNT(b.x)], 1u);
    return b;
}
__device__ __forceinline__ void xcd_barrier_complete(unsigned* bar, unsigned x, unsigned& nloc, unsigned& nx) {
    const unsigned G = gridDim.x * gridDim.y * gridDim.z;
    unsigned sum, cnt, mine, sp = 0u;
    for (;;) {
        sum = 0u; cnt = 0u; mine = 0u;
#pragma unroll
        for (unsigned j = 0; j < 16; ++j) { const unsigned c = xb_ld(&bar[XB_XCNT(j)]); sum += c; cnt += (c > 0u) ? 1u : 0u; mine = (j == x) ? c : mine; }
        if (sum == G) break;
        __builtin_amdgcn_s_sleep(1);
        if ((++sp & 255u) == 0u) { if (xb_ld(&bar[XB_TMO])) break; if (sp > XB_SPIN_CAP) { atomicAdd(&bar[XB_TMO], 1u); break; } }
    }
    nloc = mine > 0u ? mine : 1u; nx = cnt > 0u ? cnt : 1u;
}
__device__ __forceinline__ void xcd_barrier(const XcdBarrier& b) {
    asm volatile("s_waitcnt vmcnt(0)" ::: "memory");
    __syncthreads();
    if (threadIdx.x == 0) {
        unsigned* bar = b.bar;
        __builtin_amdgcn_s_waitcnt(0);
        unsigned nloc = b.st[0], nx = b.st[1];
        if (nloc == 0u) { xcd_barrier_complete(bar, b.x, nloc, nx); b.st[0] = nloc; b.st[1] = nx; }
        const unsigned old = xb_add(&bar[XB_XSUB(b.x)], 1u);
        const unsigned gen = old / nloc;
        if (old + 1u == (gen + 1u) * nloc) {
            __builtin_amdgcn_fence(__ATOMIC_RELEASE, "agent");
            asm volatile("s_waitcnt vmcnt(0)" ::: "memory");
            const unsigned og = xb_add(&bar[XB_TOP], 1u);
            const unsigned tg = og / nx;
            if (og + 1u == (tg + 1u) * nx) xb_add(&bar[XB_TOPGEN], 1u);
            else XB_SPIN(xb_ld(&bar[XB_TOPGEN]) == tg, bar);
            __builtin_amdgcn_fence(__ATOMIC_ACQUIRE, "agent");
            xb_add(&bar[XB_XGEN(b.x)], 1u);
            asm volatile("s_waitcnt vmcnt(0)" ::: "memory");
        } else {
            XB_SPIN(xb_ld(&bar[XB_XGEN(b.x)]) == gen, bar);
            __builtin_amdgcn_fence(__ATOMIC_ACQUIRE, "agent");
            asm volatile("s_waitcnt vmcnt(0)" ::: "memory");
        }
    }
    __syncthreads();
}

__device__ __forceinline__ float wave_sum(float v) {
#pragma unroll
    for (int o = 1; o < 64; o <<= 1) v += __shfl_xor(v, o);
    return v;
}
__device__ __forceinline__ float wave_max(float v) {
#pragma unroll
    for (int o = 1; o < 64; o <<= 1) v = fmaxf(v, __shfl_xor(v, o));
    return v;
}
__device__ __forceinline__ float sigmoidf_(float x) { return 1.0f / (1.0f + expf(-x)); }

template <bool DUAL, class ARow, class Epi>
__device__ __forceinline__ void gemm128_f32(float* lds, const float* __restrict__ A, int lda, const ARow& arow,
                                            const float* __restrict__ B0, const float* __restrict__ B1, int ldb, int col0, int K, const Epi& epi) {
    float* As = lds;
    float* Bs0 = lds + 16 * 132;
    float* Bs1 = Bs0 + 16 * 128;
    const int tid = threadIdx.x, tx = tid & 31, ty = tid >> 5;
    const int lr = tid >> 2, lk = (tid & 3) * 4;
    const float* ap = A + (size_t)arow(lr) * lda + lk;
    const int bk = tid >> 5, bc = (tid & 31) * 4;
    const float* bp0 = B0 + (size_t)bk * ldb + col0 + bc;
    const float* bp1 = DUAL ? (B1 + (size_t)bk * ldb + col0 + bc) : nullptr;
    float acc0[8][4], acc1[8][4];
#pragma unroll
    for (int i = 0; i < 8; ++i)
#pragma unroll
        for (int j = 0; j < 4; ++j) { acc0[i][j] = 0.f; acc1[i][j] = 0.f; }
    for (int k0 = 0; k0 < K; k0 += 16) {
        const float4 av = *(const float4*)(ap + k0);
        const float4 bv0 = *(const float4*)(bp0 + (size_t)k0 * ldb);
        float4 bv1 = make_float4(0.f, 0.f, 0.f, 0.f);
        if (DUAL) bv1 = *(const float4*)(bp1 + (size_t)k0 * ldb);
        __syncthreads();
        As[(lk + 0) * 132 + lr] = av.x; As[(lk + 1) * 132 + lr] = av.y; As[(lk + 2) * 132 + lr] = av.z; As[(lk + 3) * 132 + lr] = av.w;
        *(float4*)&Bs0[bk * 128 + bc] = bv0;
        if (DUAL) *(float4*)&Bs1[bk * 128 + bc] = bv1;
        __syncthreads();
#pragma unroll
        for (int k = 0; k < 16; ++k) {
            const float4 a0 = *(const float4*)&As[k * 132 + ty * 8], a1 = *(const float4*)&As[k * 132 + ty * 8 + 4];
            const float4 b0 = *(const float4*)&Bs0[k * 128 + tx * 4];
            const float a[8] = {a0.x, a0.y, a0.z, a0.w, a1.x, a1.y, a1.z, a1.w};
            const float b[4] = {b0.x, b0.y, b0.z, b0.w};
#pragma unroll
            for (int i = 0; i < 8; ++i)
#pragma unroll
                for (int j = 0; j < 4; ++j) acc0[i][j] = fmaf(a[i], b[j], acc0[i][j]);
            if (DUAL) {
                const float4 c0 = *(const float4*)&Bs1[k * 128 + tx * 4];
                const float c[4] = {c0.x, c0.y, c0.z, c0.w};
#pragma unroll
                for (int i = 0; i < 8; ++i)
#pragma unroll
                    for (int j = 0; j < 4; ++j) acc1[i][j] = fmaf(a[i], c[j], acc1[i][j]);
            }
        }
    }
    __syncthreads();
#pragma unroll
    for (int i = 0; i < 8; ++i) {
        const float4 v0 = make_float4(acc0[i][0], acc0[i][1], acc0[i][2], acc0[i][3]);
        const float4 v1 = make_float4(acc1[i][0], acc1[i][1], acc1[i][2], acc1[i][3]);
        epi(ty * 8 + i, col0 + tx * 4, v0, v1);
    }
}

#define LP(i, stride) (args.in[i] + (size_t)l * (size_t)(stride))
struct Args { const float* in[26]; float* out; unsigned char* ws; int l_lo, l_hi, ph_lo, ph_hi, use_bar, pad; };

struct RowLin { int row0; __device__ __forceinline__ int operator()(int r) const { return row0 + r; } };
struct RowList { const int* list; int r0, n; __device__ __forceinline__ int operator()(int r) const { int i = r0 + r; if (i > n - 1) i = n - 1; return list[i]; } };
struct RowClamp { int base, r0, n; __device__ __forceinline__ int operator()(int r) const { int i = r0 + r; if (i > n - 1) i = n - 1; return base + i; } };

struct EpiBias { float* C; int ldc; int row0; const float* bias; int cofs;
    __device__ __forceinline__ void operator()(int r, int c, float4 v, float4) const {
        const float4 b = *(const float4*)(bias + c);
        *(float4*)(C + (size_t)(row0 + r) * ldc + cofs + c) = make_float4(v.x + b.x, v.y + b.y, v.z + b.z, v.w + b.w); } };
struct EpiOut { float* C; int row0; const float* bias; const float* xres;
    __device__ __forceinline__ void operator()(int r, int c, float4 v, float4) const {
        const float4 b = *(const float4*)(bias + c); const float4 xr = *(const float4*)(xres + (size_t)(row0 + r) * D + c);
        *(float4*)(C + (size_t)(row0 + r) * D + c) = make_float4(v.x + b.x + ALPHA * xr.x, v.y + b.y + ALPHA * xr.y, v.z + b.z + ALPHA * xr.z, v.w + b.w + ALPHA * xr.w); } };
__device__ __forceinline__ float swiglu_(float g, float u) {
    g = fminf(g, 7.0f); u = fminf(fmaxf(u, -7.0f), 7.0f);
    return (u + 1.0f) * g * sigmoidf_(1.702f * g);
}
struct EpiAct { float* H; int base, r0, n; const float* bg; const float* bu;
    __device__ __forceinline__ void operator()(int r, int c, float4 g, float4 u) const {
        if (r0 + r >= n) return;
        const float4 b0 = *(const float4*)(bg + c), b1 = *(const float4*)(bu + c);
        *(float4*)(H + (size_t)(base + r0 + r) * D + c) = make_float4(swiglu_(g.x + b0.x, u.x + b1.x), swiglu_(g.y + b0.y, u.y + b1.y), swiglu_(g.z + b0.z, u.z + b1.z), swiglu_(g.w + b0.w, u.w + b1.w)); } };
struct EpiDown { float* Y; int base, r0, n; const float* bias;
    __device__ __forceinline__ void operator()(int r, int c, float4 v, float4) const {
        if (r0 + r >= n) return;
        const float4 b = *(const float4*)(bias + c);
        *(float4*)(Y + (size_t)(base + r0 + r) * D + c) = make_float4(v.x + b.x, v.y + b.y, v.z + b.z, v.w + b.w); } };

__device__ __forceinline__ void ln_row16(float4 (&v)[4], const float* g, const float* b, int lane) {
    float s = 0.f;
#pragma unroll
    for (int j = 0; j < 4; ++j) s += (v[j].x + v[j].y) + (v[j].z + v[j].w);
    const float mean = wave_sum(s) * (1.f / D);
    float s2 = 0.f;
#pragma unroll
    for (int j = 0; j < 4; ++j) { v[j].x -= mean; v[j].y -= mean; v[j].z -= mean; v[j].w -= mean; s2 += (v[j].x * v[j].x + v[j].y * v[j].y) + (v[j].z * v[j].z + v[j].w * v[j].w); }
    const float rstd = 1.0f / sqrtf(wave_sum(s2) * (1.f / D) + LN_EPS);
#pragma unroll
    for (int j = 0; j < 4; ++j) { const float4 gg = *(const float4*)(g + lane * 4 + 256 * j), bb = *(const float4*)(b + lane * 4 + 256 * j);
        v[j].x = v[j].x * rstd * gg.x + bb.x; v[j].y = v[j].y * rstd * gg.y + bb.y; v[j].z = v[j].z * rstd * gg.z + bb.z; v[j].w = v[j].w * rstd * gg.w + bb.w; }
}

struct Ctx { float* lds; unsigned* ctl; int* list; int* tinfo; float* tprob; float* hc; float* z; float* cat; float* x1; float* xc; float* Hb; float* Yb;
    int tid, lane, wave, bid, nb, gw, NGW; };
#define IN(k) ((PH) == (k))
#define SEAM() do { if (args.use_bar) xcd_barrier(bar); } while (0)
template <int l, int PH>
__device__ __forceinline__ void layer_body(const Args& args, const XcdBarrier& bar, int* s_cnt, int* s_off, int* s_tp) {
    extern __shared__ __attribute__((aligned(16))) unsigned char lds_raw[];
    float* lds = (float*)lds_raw;
    const int tid = threadIdx.x, lane = tid & 63, wave = tid >> 6;
    const int bid = blockIdx.x, nb = gridDim.x;
    const int gw = bid * NWAVES + wave, NGW = nb * NWAVES;
    unsigned char* ws = args.ws;
    unsigned* ctl = (unsigned*)(ws + WS_CTL);
    int* list = (int*)(ws + WS_LIST);
    int* tinfo = (int*)(ws + WS_TINFO);
    float* tprob = (float*)(ws + WS_TPROB);
    float* hc = (float*)(ws + WS_HC);
    float* z = (float*)(ws + WS_Z);
    float* cat = (float*)(ws + WS_CAT);
    float* x1 = (float*)(ws + WS_X1);
    float* xc = (float*)(ws + WS_XC);
    float* Hb = (float*)(ws + WS_H);
    float* Yb = (float*)(ws + WS_Y);
        const float* xin = (l == 0) ? args.in[0] : xc;
        float* xout = (l == 1) ? args.out : xc;
        unsigned* cnt = ctl + CW_CNT + l * NE;

        if (IN(0)) {
            const float* w_in = LP(1, D * DIN);
            const float* b_in = LP(2, DIN);
            for (int it = bid; it < 128 * 18; it += nb) {
                const int rt = it / 18, ct = it % 18;
                RowLin ar{rt * 128}; EpiBias ep{z, DIN, rt * 128, b_in, 0};
                gemm128_f32<false>(lds, xin, D, ar, w_in, nullptr, DIN, ct * 128, D, ep);
            }
            SEAM();
        }
        if (IN(1)) {
            const float* w_pool = LP(3, 4 * 64 * 64);
            const float* pool_scale = LP(4, 256);
            const float* rpb = LP(5, 8 * 15 * 31);
            const float* conv_dw = LP(6, CONVK * CW);
            const float* conv_dw_b = LP(7, CW);
            const float* conv_ln_g = LP(8, CW);
            const float* conv_ln_b = LP(9, CW);
            for (int it = gw; it < NTOK * 4; it += NGW) {
                const int t = it >> 2, g = it & 3, b = t / S, s = t % S, hw = 1 << g;
                const int lo = max(s - hw, 0), hi = min(s + hw, S);
                float sum = 0.f;
                for (int j = lo; j < hi; ++j) sum += z[(size_t)(b * S + j) * DIN + OFF_POOL + g * 64 + lane];
                const float d = sum / (float)(hi - lo) - z[(size_t)t * DIN + OFF_POOL + g * 64 + lane];
                float o = 0.f;
                const float* wp = w_pool + (size_t)g * 64 * 64 + lane;
#pragma unroll 8
                for (int c = 0; c < 64; ++c) o = fmaf(__shfl(d, c), wp[c * 64], o);
                cat[(size_t)t * D + g * 64 + lane] = o * pool_scale[g * 64 + lane];
            }
            for (int it = gw; it < NTOK * 8; it += NGW) {
                const int t = it >> 3, h = it & 7, b = t / S, s = t % S, qr = s >> 6, qc = s & 63;
                const int sr = min(max(qr - 4, 0), 120), sc = min(max(qc - 8, 0), 48);
                float4 q[16];
                const float* qp = z + (size_t)t * DIN + OFF_Q + h * 64;
#pragma unroll
                for (int i = 0; i < 16; ++i) q[i] = *(const float4*)(qp + 4 * i);
                float sc2[2]; int kt[2];
#pragma unroll
                for (int u = 0; u < 2; ++u) {
                    const int j = lane + 64 * u, kr = sr + (j >> 4), kc = sc + (j & 15);
                    kt[u] = b * S + kr * 64 + kc;
                    const float* kp = z + (size_t)kt[u] * DIN + OFF_K + h * 64;
                    float a = 0.f;
#pragma unroll
                    for (int i = 0; i < 16; ++i) { const float4 kv = *(const float4*)(kp + 4 * i); a = fmaf(q[i].x, kv.x, a); a = fmaf(q[i].y, kv.y, a); a = fmaf(q[i].z, kv.z, a); a = fmaf(q[i].w, kv.w, a); }
                    sc2[u] = a * 0.125f + rpb[(h * 15 + (kr - qr + 7)) * 31 + (kc - qc + 15)];
                }
                const float m = wave_max(fmaxf(sc2[0], sc2[1]));
                float p0 = expf(sc2[0] - m), p1 = expf(sc2[1] - m);
                const float inv = 1.0f / wave_sum(p0 + p1);
                p0 *= inv; p1 *= inv;
                float o = 0.f;
                const float* vp = z + OFF_V + h * 64 + lane;
                for (int j = 0; j < 64; ++j) { const int k0 = __shfl(kt[0], j); o = fmaf(__shfl(p0, j), vp[(size_t)k0 * DIN], o); }
                for (int j = 0; j < 64; ++j) { const int k1 = __shfl(kt[1], j); o = fmaf(__shfl(p1, j), vp[(size_t)k1 * DIN], o); }
                cat[(size_t)t * D + 256 + h * 64 + lane] = o;
            }
            {
                float* hbuf = lds;
                float* cbuf = lds + 62 * 256;
                for (int tile = bid; tile < NTOK / 32; tile += nb) {
                    const int t0 = tile * 32, b = t0 / S, s0 = t0 % S;
                    __syncthreads();
                    for (int idx = tid; idx < 62 * 256; idx += NTHR) {
                        const int r = idx >> 8, c = idx & 255, s = s0 - 15 + r;
                        float v = 0.f;
                        if (s >= 0 && s < S) { const float* zp = z + (size_t)(b * S + s) * DIN; v = zp[OFF_CA + c] * sigmoidf_(zp[OFF_CG + c]); }
                        hbuf[idx] = v;
                    }
                    __syncthreads();
                    {
                        const int c = tid & 255, half = tid >> 8;
                        float wv[CONVK];
#pragma unroll
                        for (int j = 0; j < CONVK; ++j) wv[j] = conv_dw[j * CW + c];
                        const float bb = conv_dw_b[c];
                        for (int i = half * 16; i < half * 16 + 16; ++i) {
                            float a = bb;
#pragma unroll
                            for (int j = 0; j < CONVK; ++j) a = fmaf(hbuf[(i + j) * 256 + c], wv[j], a);
                            cbuf[i * 256 + c] = a;
                        }
                    }
                    __syncthreads();
                    for (int i = wave; i < 32; i += NWAVES) {
                        float4 v = *(const float4*)&cbuf[i * 256 + lane * 4];
                        const float mean = wave_sum((v.x + v.y) + (v.z + v.w)) * (1.f / 256.f);
                        v.x -= mean; v.y -= mean; v.z -= mean; v.w -= mean;
                        const float rstd = 1.0f / sqrtf(wave_sum((v.x * v.x + v.y * v.y) + (v.z * v.z + v.w * v.w)) * (1.f / 256.f) + LN_EPS);
                        const float4 gg = *(const float4*)(conv_ln_g + lane * 4), bb = *(const float4*)(conv_ln_b + lane * 4);
                        float4 y = make_float4(v.x * rstd * gg.x + bb.x, v.y * rstd * gg.y + bb.y, v.z * rstd * gg.z + bb.z, v.w * rstd * gg.w + bb.w);
                        y.x *= sigmoidf_(y.x); y.y *= sigmoidf_(y.y); y.z *= sigmoidf_(y.z); y.w *= sigmoidf_(y.w);
                        *(float4*)(hc + (size_t)(t0 + i) * CW + lane * 4) = y;
                    }
                }
                __syncthreads();
            }
            SEAM();
        }
        if (IN(2)) {
            const float* w_pw = LP(10, CW * CW);
            const float* b_pw = LP(11, CW);
            for (int it = bid; it < 128 * 2; it += nb) {
                const int rt = it >> 1, ct = it & 1;
                RowLin ar{rt * 128}; EpiBias ep{cat, D, rt * 128, b_pw, 768};
                gemm128_f32<false>(lds, hc, CW, ar, w_pw, nullptr, CW, ct * 128, CW, ep);
            }
            SEAM();
        }
        if (IN(3)) {
            const float* w_out = LP(12, D * D);
            const float* b_out = LP(13, D);
            for (int it = bid; it < 128 * 8; it += nb) {
                const int rt = it >> 3, ct = it & 7;
                RowLin ar{rt * 128}; EpiOut ep{x1, rt * 128, b_out, xin};
                gemm128_f32<false>(lds, cat, D, ar, w_out, nullptr, D, ct * 128, D, ep);
            }
            SEAM();
        }
        if (IN(4)) {
            const float* ln1_g = LP(14, D);
            const float* ln1_b = LP(15, D);
            const float* w_router = LP(16, D * NE);
            const float* b_router = LP(17, NE);
            for (int t = gw; t < NTOK; t += NGW) {
                float4 v[4];
                float* xr = x1 + (size_t)t * D + lane * 4;
#pragma unroll
                for (int j = 0; j < 4; ++j) v[j] = *(const float4*)(xr + 256 * j);
                ln_row16(v, ln1_g, ln1_b, lane);
#pragma unroll
                for (int j = 0; j < 4; ++j) *(float4*)(xr + 256 * j) = v[j];
                float lg[NE];
#pragma unroll
                for (int e = 0; e < NE; ++e) lg[e] = 0.f;
#pragma unroll
                for (int j = 0; j < 4; ++j) {
                    const float xv[4] = {v[j].x, v[j].y, v[j].z, v[j].w};
#pragma unroll
                    for (int i = 0; i < 4; ++i) {
                        const float* wr = w_router + (size_t)(lane * 4 + 256 * j + i) * NE;
#pragma unroll
                        for (int e4 = 0; e4 < 8; ++e4) { const float4 w4 = *(const float4*)(wr + 4 * e4);
                            lg[4 * e4 + 0] = fmaf(xv[i], w4.x, lg[4 * e4 + 0]); lg[4 * e4 + 1] = fmaf(xv[i], w4.y, lg[4 * e4 + 1]);
                            lg[4 * e4 + 2] = fmaf(xv[i], w4.z, lg[4 * e4 + 2]); lg[4 * e4 + 3] = fmaf(xv[i], w4.w, lg[4 * e4 + 3]); }
                    }
                }
#pragma unroll
                for (int e = 0; e < NE; ++e) lg[e] = wave_sum(lg[e]) + b_router[e];
                unsigned taken = 0u; float tv[4]; int ti[4];
#pragma unroll
                for (int k = 0; k < 4; ++k) {
                    float best = -3.0e38f; int bi = 0;
#pragma unroll
                    for (int e = 0; e < NE; ++e) { const bool ok = !((taken >> e) & 1u) && (lg[e] > best); best = ok ? lg[e] : best; bi = ok ? e : bi; }
                    taken |= 1u << bi; tv[k] = best; ti[k] = bi;
                }
                const float e1 = expf(tv[1] - tv[0]), e2 = expf(tv[2] - tv[0]), e3 = expf(tv[3] - tv[0]);
                const float inv = 1.0f / (1.0f + e1 + e2 + e3);
                const float pr[4] = {inv, e1 * inv, e2 * inv, e3 * inv};
                if (lane == 0) {
#pragma unroll
                    for (int k = 0; k < 4; ++k) {
                        const unsigned pos = atomicAdd(&cnt[ti[k]], 1u);
                        list[ti[k] * NTOK + pos] = t;
                        tinfo[t * 4 + k] = (ti[k] << 16) | (int)pos;
                        tprob[t * 4 + k] = pr[k];
                    }
                }
            }
            SEAM();
        }
        if (IN(5) || IN(6) || IN(7)) {
            __syncthreads();
            if (tid == 0) {
                int o = 0, tp = 0;
                for (int e = 0; e < NE; ++e) { const int c = (int)__hip_atomic_load(&cnt[e], __ATOMIC_RELAXED, __HIP_MEMORY_SCOPE_AGENT); s_cnt[e] = c; s_off[e] = o; s_tp[e] = tp; o += c; tp += (c + 127) >> 7; }
                s_off[NE] = o; s_tp[NE] = tp;
            }
            __syncthreads();
        }
        if (IN(5)) {
            const float* w_gate = LP(18, NE * D * D);
            const float* b_gate = LP(19, NE * D);
            const float* w_up = LP(20, NE * D * D);
            const float* b_up = LP(21, NE * D);
            const int ntile = s_tp[NE];
            for (int it = bid; it < ntile * 8; it += nb) {
                const int rt = it >> 3, ct = it & 7;
                int e = 0;
                while (e < NE - 1 && rt >= s_tp[e + 1]) ++e;
                const int r0 = (rt - s_tp[e]) * 128, n = s_cnt[e];
                RowList ar{list + e * NTOK, r0, n};
                EpiAct ep{Hb, s_off[e], r0, n, b_gate + (size_t)e * D, b_up + (size_t)e * D};
                gemm128_f32<true>(lds, x1, D, ar, w_gate + (size_t)e * D * D, w_up + (size_t)e * D * D, D, ct * 128, D, ep);
            }
            SEAM();
        }
        if (IN(6)) {
            const float* w_down = LP(22, NE * D * D);
            const float* b_down = LP(23, NE * D);
            const int ntile = s_tp[NE];
            for (int it = bid; it < ntile * 8; it += nb) {
                const int rt = it >> 3, ct = it & 7;
                int e = 0;
                while (e < NE - 1 && rt >= s_tp[e + 1]) ++e;
                const int r0 = (rt - s_tp[e]) * 128, n = s_cnt[e];
                RowClamp ar{s_off[e], r0, n};
                EpiDown ep{Yb, s_off[e], r0, n, b_down + (size_t)e * D};
                gemm128_f32<false>(lds, Hb, D, ar, w_down + (size_t)e * D * D, nullptr, D, ct * 128, D, ep);
            }
            SEAM();
        }
        if (IN(7)) {
            const float* ln2_g = LP(24, D);
            const float* ln2_b = LP(25, D);
            for (int t = gw; t < NTOK; t += NGW) {
                float4 v[4];
                const float* xr = x1 + (size_t)t * D + lane * 4;
#pragma unroll
                for (int j = 0; j < 4; ++j) { v[j] = *(const float4*)(xr + 256 * j); v[j].x *= ALPHA; v[j].y *= ALPHA; v[j].z *= ALPHA; v[j].w *= ALPHA; }
                float4 f[4];
#pragma unroll
                for (int j = 0; j < 4; ++j) f[j] = make_float4(0.f, 0.f, 0.f, 0.f);
#pragma unroll
                for (int k = 0; k < 4; ++k) {
                    const int ti = tinfo[t * 4 + k]; const float p = tprob[t * 4 + k];
                    const int e = ti >> 16, pos = ti & 0xffff;
                    const float* yr = Yb + (size_t)(s_off[e] + pos) * D + lane * 4;
#pragma unroll
                    for (int j = 0; j < 4; ++j) { const float4 y = *(const float4*)(yr + 256 * j); f[j].x = fmaf(p, y.x, f[j].x); f[j].y = fmaf(p, y.y, f[j].y); f[j].z = fmaf(p, y.z, f[j].z); f[j].w = fmaf(p, y.w, f[j].w); }
                }
#pragma unroll
                for (int j = 0; j < 4; ++j) { v[j].x += f[j].x; v[j].y += f[j].y; v[j].z += f[j].z; v[j].w += f[j].w; }
                ln_row16(v, ln2_g, ln2_b, lane);
                float* orow = xout + (size_t)t * D + lane * 4;
#pragma unroll
                for (int j = 0; j < 4; ++j) *(float4*)(orow + 256 * j) = v[j];
            }
            if (l + 1 < args.l_hi) SEAM();
        }
}
#undef IN
#undef SEAM

template <int PH>
__global__ void __launch_bounds__(NTHR, 2) fwd(Args args) {
    __shared__ uint4 xb_words;
    __shared__ int s_cnt[NE], s_off[NE + 1], s_tp[NE + 1];
    unsigned* ctl = (unsigned*)(args.ws + WS_CTL);
    if (threadIdx.x == 0) xb_words = make_uint4(0u, 0u, 0u, 0u);
    __syncthreads();
    XcdBarrier bar; bar.bar = ctl + CW_BAR; bar.x = 0; bar.st = (volatile LAS unsigned*)&xb_words;
    if (args.use_bar) bar = xcd_barrier_post(ctl + CW_BAR, (volatile LAS unsigned*)&xb_words);
    if (args.l_lo <= 0 && 0 < args.l_hi) layer_body<0, PH>(args, bar, s_cnt, s_off, s_tp);
    if (args.l_lo <= 1 && 1 < args.l_hi) layer_body<1, PH>(args, bar, s_cnt, s_off, s_tp);
}


extern "C" void kernel_launch(void* const* d_in, const int* in_sizes, int n_in, void* d_out, int out_size, void* d_ws, size_t ws_size, hipStream_t stream) {
    static int grid = 0;
    if (grid == 0) {
        if (n_in != 26 || out_size != NTOK * D || ws_size < WS_END) { fprintf(stderr, "kernel_launch: unexpected shapes n_in %d out %d ws %zu\n", n_in, out_size, ws_size); grid = -1; return; }
        int dev = 0, cus = 0;
        if (hipGetDevice(&dev) != hipSuccess || hipDeviceGetAttribute(&cus, hipDeviceAttributeMultiprocessorCount, dev) != hipSuccess) { grid = -1; return; }
        bool ok = true;
        ok &= hipFuncSetAttribute((const void*)fwd<0>, hipFuncAttributeMaxDynamicSharedMemorySize, LDS_BYTES) == hipSuccess;
        ok &= hipFuncSetAttribute((const void*)fwd<1>, hipFuncAttributeMaxDynamicSharedMemorySize, LDS_BYTES) == hipSuccess;
        ok &= hipFuncSetAttribute((const void*)fwd<2>, hipFuncAttributeMaxDynamicSharedMemorySize, LDS_BYTES) == hipSuccess;
        ok &= hipFuncSetAttribute((const void*)fwd<3>, hipFuncAttributeMaxDynamicSharedMemorySize, LDS_BYTES) == hipSuccess;
        ok &= hipFuncSetAttribute((const void*)fwd<4>, hipFuncAttributeMaxDynamicSharedMemorySize, LDS_BYTES) == hipSuccess;
        ok &= hipFuncSetAttribute((const void*)fwd<5>, hipFuncAttributeMaxDynamicSharedMemorySize, LDS_BYTES) == hipSuccess;
        ok &= hipFuncSetAttribute((const void*)fwd<6>, hipFuncAttributeMaxDynamicSharedMemorySize, LDS_BYTES) == hipSuccess;
        ok &= hipFuncSetAttribute((const void*)fwd<7>, hipFuncAttributeMaxDynamicSharedMemorySize, LDS_BYTES) == hipSuccess;
        if (!ok) { fprintf(stderr, "hipFuncSetAttribute failed\n"); grid = -1; return; }
        grid = cus;
    }
    if (grid < 0) return;
    (void)hipMemsetAsync((char*)d_ws + WS_CTL, 0, CTL_BYTES, stream);
    Args a{};
    for (int i = 0; i < 26; ++i) a.in[i] = (const float*)d_in[i];
    a.out = (float*)d_out; a.ws = (unsigned char*)d_ws;
    for (int l = 0; l < 2; ++l) {
        a.l_lo = l; a.l_hi = l + 1; a.ph_lo = 0; a.ph_hi = 8; a.use_bar = 0; a.pad = 0;
        hipLaunchKernelGGL(fwd<0>, dim3(grid), dim3(NTHR), LDS_BYTES, stream, a);
        hipLaunchKernelGGL(fwd<1>, dim3(grid), dim3(NTHR), LDS_BYTES, stream, a);
        hipLaunchKernelGGL(fwd<2>, dim3(grid), dim3(NTHR), LDS_BYTES, stream, a);
        hipLaunchKernelGGL(fwd<3>, dim3(grid), dim3(NTHR), LDS_BYTES, stream, a);
        hipLaunchKernelGGL(fwd<4>, dim3(grid), dim3(NTHR), LDS_BYTES, stream, a);
        hipLaunchKernelGGL(fwd<5>, dim3(grid), dim3(NTHR), LDS_BYTES, stream, a);
        hipLaunchKernelGGL(fwd<6>, dim3(grid), dim3(NTHR), LDS_BYTES, stream, a);
        hipLaunchKernelGGL(fwd<7>, dim3(grid), dim3(NTHR), LDS_BYTES, stream, a);
    }
}
```

```cpp
#include <hip/hip_runtime.h>
#include <cstdio>
#include <cstdint>

#ifndef MK_SPLIT
#define MK_SPLIT 0
#endif

#define LAS __attribute__((address_space(3)))
#define GAS __attribute__((address_space(1)))

typedef unsigned short bf16_t;
typedef short bf16x8 __attribute__((ext_vector_type(8)));
typedef float f32x4 __attribute__((ext_vector_type(4)));
typedef float f32x2 __attribute__((ext_vector_type(2)));
typedef unsigned u32x4 __attribute__((ext_vector_type(4)));
typedef unsigned u32x2 __attribute__((ext_vector_type(2)));

constexpr int NTOK = 16384, S = 8192, D = 1024, DIN = 2304;
constexpr int OFF_POOL = 0, OFF_Q = 256, OFF_K = 768, OFF_V = 1280, OFF_CA = 1792, OFF_CG = 2048;
constexpr int NE = 32, CONVK = 31, CW = 256;
constexpr float ALPHA = 1.41421356237309515f;
constexpr float LN_EPS = 1e-5f;
constexpr int NTHR = 512, NWAVES = 8;
constexpr int MAXROWS = 73728, MAXTILES = MAXROWS / 256;

constexpr int STAGE_BYTES_ = 131072;
constexpr int MISC_OFF = STAGE_BYTES_;
constexpr int MISC_XB = 0, MISC_OFFE = 64  , MISC_NT = 448  , MISC_TILEE = 512  ;
constexpr int LDS_BYTES = 147456;

constexpr size_t MiB = 1u << 20;
constexpr size_t WS_CTL = 0, CTL_BYTES = 1 * MiB;
constexpr size_t WS_TINFO = 1 * MiB;
constexpr size_t WS_TPROB = 1 * MiB + 512 * 1024;
constexpr size_t WS_WIN = 2 * MiB;
constexpr size_t WS_WOUT = 7 * MiB;
constexpr size_t WS_WPW = 9 * MiB;
constexpr size_t WS_WGU = 10 * MiB;
constexpr size_t WS_WD = 138 * MiB;
constexpr size_t WS_XB = 202 * MiB;
constexpr size_t WS_Z = 234 * MiB;
constexpr size_t WS_HC = 306 * MiB;
constexpr size_t WS_CAT = 314 * MiB;
constexpr size_t WS_X1 = 346 * MiB;
constexpr size_t WS_X1B = 410 * MiB;
constexpr size_t WS_XC = 442 * MiB;
constexpr size_t WS_XS = 506 * MiB;
constexpr size_t WS_H = 650 * MiB;
constexpr size_t WS_END = 794 * MiB;
constexpr int CW_CNT = 64;
constexpr int CW_BAR = 4096;

#define XB_TMO      128
#define XB_XCNT(j)  (256  + 64 * (j))
#define XB_XSUB(j)  (1280 + 64 * (j))
#define XB_XGEN(j)  (2304 + 64 * (j))
#define XB_TOP      3328
#define XB_TOPGEN   3392
#define XCD_BAR_WORDS 3456
#define XB_SPIN_CAP (1u << 18)

__device__ __forceinline__ unsigned xb_ld(unsigned* p)              { return __hip_atomic_load(p, __ATOMIC_RELAXED, __HIP_MEMORY_SCOPE_AGENT); }
__device__ __forceinline__ unsigned xb_add(unsigned* p, unsigned v) { return __hip_atomic_fetch_add(p, v, __ATOMIC_RELAXED, __HIP_MEMORY_SCOPE_AGENT); }
__device__ __forceinline__ unsigned xb_xcc_id() { return (unsigned)__builtin_amdgcn_s_getreg((3 << 11) | 20) & 0xFu; }
#define XB_SPIN(cond, bar) do { unsigned _sp = 0; while (cond) { __builtin_amdgcn_s_sleep(1); \
    if ((++_sp & 255u) == 0u) { if (xb_ld(&(bar)[XB_TMO])) break; if (_sp > XB_SPIN_CAP) { atomicAdd(&(bar)[XB_TMO], 1u); break; } } } } while (0)

struct XcdBarrier { unsigned* bar; unsigned x; volatile LAS unsigned* st; };

__device__ __forceinline__ XcdBarrier xcd_barrier_post(unsigned* bar, volatile LAS unsigned* st) {
    XcdBarrier b; b.bar = bar; b.x = xb_xcc_id(); b.st = st;
    if (threadIdx.x == 0) (void)xb_add(&bar[XB_XCNT(b.x)], 1u);
    return b;
}
__device__ __forceinline__ void xcd_barrier_complete(unsigned* bar, unsigned x, unsigned& nloc, unsigned& nx) {
    const unsigned G = gridDim.x * gridDim.y * gridDim.z;
    unsigned sum, cnt, mine, sp = 0u;
    for (;;) {
        sum = 0u; cnt = 0u; mine = 0u;
#pragma unroll
        for (unsigned j = 0; j < 16; ++j) { const unsigned c = xb_ld(&bar[XB_XCNT(j)]); sum += c; cnt += (c > 0u) ? 1u : 0u; mine = (j == x) ? c : mine; }
        if (sum == G) break;
        __builtin_amdgcn_s_sleep(1);
        if ((++sp & 255u) == 0u) { if (xb_ld(&bar[XB_TMO])) break; if (sp > XB_SPIN_CAP) { atomicAdd(&bar[XB_TMO], 1u); break; } }
    }
    nloc = mine > 0u ? mine : 1u; nx = cnt > 0u ? cnt : 1u;
}
__device__ __forceinline__ void xcd_barrier(const XcdBarrier& b) {
    asm volatile("s_waitcnt vmcnt(0)" ::: "memory");
    __syncthreads();
    if (threadIdx.x == 0) {
        unsigned* bar = b.bar;
        __builtin_amdgcn_s_waitcnt(0);
        unsigned nloc = b.st[0], nx = b.st[1];
        if (nloc == 0u) { xcd_barrier_complete(bar, b.x, nloc, nx); b.st[0] = nloc; b.st[1] = nx; }
        const unsigned old = xb_add(&bar[XB_XSUB(b.x)], 1u);
        const unsigned gen = old / nloc;
        if (old + 1u == (gen + 1u) * nloc) {
            __builtin_amdgcn_fence(__ATOMIC_RELEASE, "agent");
            asm volatile("s_waitcnt vmcnt(0)" ::: "memory");
            const unsigned og = xb_add(&bar[XB_TOP], 1u);
            const unsigned tg = og / nx;
            if (og + 1u == (tg + 1u) * nx) xb_add(&bar[XB_TOPGEN], 1u);
            else XB_SPIN(xb_ld(&bar[XB_TOPGEN]) == tg, bar);
            __builtin_amdgcn_fence(__ATOMIC_ACQUIRE, "agent");
            xb_add(&bar[XB_XGEN(b.x)], 1u);
            asm volatile("s_waitcnt vmcnt(0)" ::: "memory");
        } else {
            XB_SPIN(xb_ld(&bar[XB_XGEN(b.x)]) == gen, bar);
            __builtin_amdgcn_fence(__ATOMIC_ACQUIRE, "agent");
            asm volatile("s_waitcnt vmcnt(0)" ::: "memory");
        }
    }
    __syncthreads();
}

__device__ __forceinline__ float wave_sum(float v) {
#pragma unroll
    for (int o = 1; o < 64; o <<= 1) v += __shfl_xor(v, o);
    return v;
}
__device__ __forceinline__ float wave_max(float v) {
#pragma unroll
    for (int o = 1; o < 64; o <<= 1) v = fmaxf(v, __shfl_xor(v, o));
    return v;
}
__device__ __forceinline__ float sigmoidf_(float x) { return 1.0f / (1.0f + expf(-x)); }
__device__ __forceinline__ float sigmoid_fast(float x) { return __builtin_amdgcn_rcpf(1.0f + __builtin_amdgcn_exp2f(-1.44269504089f * x)); }
__device__ __forceinline__ unsigned cvt_pk_bf16(float lo, float hi) { unsigned r; asm volatile("v_cvt_pk_bf16_f32 %0, %1, %2" : "=v"(r) : "v"(lo), "v"(hi)); return r; }
__device__ __forceinline__ float bf2f(bf16_t b) { return __uint_as_float(((unsigned)b) << 16); }
__device__ __forceinline__ float bflo(unsigned w) { return __uint_as_float(w << 16); }
__device__ __forceinline__ float bfhi(unsigned w) { return __uint_as_float(w & 0xffff0000u); }
__device__ __forceinline__ void unpack8(const u32x4 w, float (&f)[8]) {
    f[0] = bflo(w.x); f[1] = bfhi(w.x); f[2] = bflo(w.y); f[3] = bfhi(w.y); f[4] = bflo(w.z); f[5] = bfhi(w.z); f[6] = bflo(w.w); f[7] = bfhi(w.w);
}

namespace pg8 {
#define PG8_LAS __attribute__((address_space(3)))
constexpr int BM = 256, BK = 64, HALF = 128, HTB = HALF * BK * 2, STAGE_BYTES = 8 * HTB, NXCD = 8, WGM = 8;

__host__ __device__ __forceinline__ int lds_byte(int r, int c) { const int st = (r >> 4) * 2 + (c >> 5), rr = r & 15, cc = c & 31, ob = rr * 64 + cc * 2; return st * 1024 + (ob ^ (((ob >> 9) & 1) << 5)); }
__host__ __device__ __forceinline__ void stage_rc(int b, int& R, int& C) { const int st = b / 1024, sb = b % 1024, swz = sb ^ (((sb >> 9) & 1) << 5); R = (st >> 1) * 16 + swz / 64; C = (st & 1) * 32 + (swz % 64) / 2; }
__host__ __device__ __forceinline__ int perm32(int rho) { const int n = rho >> 4, i = rho & 15; return 8 * (i >> 2) + 4 * n + (i & 3); }

struct Unit { int pm, pn, e; const char* a; const char* b; };

struct DenseOrder {
    int nM, nN, nwg, G, c; const char* A; const char* Bt; size_t tstep;
    __device__ __forceinline__ void init(const void* A_, const void* Bt_, int M, int N, int K, int G_, int c_) { nM = M / BM; nN = N / BM; nwg = nM * nN; G = G_; c = c_; A = (const char*)A_; Bt = (const char*)Bt_; tstep = (size_t)BM * K * 2; }
    __device__ __forceinline__ bool next(int i, Unit& u) const {
        const long L = (long)i * G + c; if (L >= nwg) return false;
        int wgid = (int)L; { const int q = nwg / NXCD, r = nwg % NXCD, xcd = wgid % NXCD, off = wgid / NXCD; wgid = (xcd < r ? xcd * (q + 1) : r * (q + 1) + (xcd - r) * q) + off; }
        const int nig = WGM * nN, gid = wgid / nig, fm = gid * WGM, gsz = (nM - fm) < WGM ? (nM - fm) : WGM;
        u.pm = fm + ((wgid % nig) % gsz); u.pn = (wgid % nig) / gsz; u.e = 0;
        u.a = A + (size_t)u.pm * tstep; u.b = Bt + (size_t)u.pn * tstep; return true;
    }
};
struct MoeOrder {
    int ntiles, nPn, G, c; const char* A; const char* Bt; size_t tstep, estride; const LAS unsigned char* tile_e;
    __device__ __forceinline__ bool next(int i, Unit& u) const {
        const int L = i * G + c; if (L >= ntiles * nPn) return false;
        u.pm = L / nPn; u.pn = L - u.pm * nPn; u.e = __builtin_amdgcn_readfirstlane((int)tile_e[u.pm]);
        u.a = A + (size_t)u.pm * tstep; u.b = Bt + (size_t)u.e * estride + (size_t)u.pn * tstep; return true;
    }
};

struct EpiBf16 {
    static constexpr bool PERM = true;
    bf16_t* O; int ldc; const float* bias; size_t bias_estride;
    __device__ __forceinline__ void operator()(const f32x4 (&acc)[2][2][4][2], const Unit& u, int wr, int wc, int fr, int fq) const {
        const int row0 = u.pm * BM + wr * 64 + fr, col0 = u.pn * BM + wc * 32 + 8 * fq;
        const float* bp = bias + (size_t)u.e * bias_estride + col0;
        f32x4 bv[2][2];
#pragma unroll
        for (int bj = 0; bj < 2; ++bj)
#pragma unroll
            for (int n = 0; n < 2; ++n) bv[bj][n] = *(const f32x4*)(bp + bj * HALF + 4 * n);
#pragma unroll
        for (int ai = 0; ai < 2; ++ai)
#pragma unroll
            for (int m = 0; m < 4; ++m) { bf16_t* rowp = O + (size_t)(row0 + ai * HALF + m * 16) * ldc + col0;
#pragma unroll
                for (int bj = 0; bj < 2; ++bj) { const f32x4 v0 = acc[ai][bj][m][0] + bv[bj][0], v1 = acc[ai][bj][m][1] + bv[bj][1];
                    u32x4 w; w.x = cvt_pk_bf16(v0[0], v0[1]); w.y = cvt_pk_bf16(v0[2], v0[3]); w.z = cvt_pk_bf16(v1[0], v1[1]); w.w = cvt_pk_bf16(v1[2], v1[3]);
                    *(u32x4*)(rowp + bj * HALF) = w; } }
    }
};
struct EpiResF32 {
    static constexpr bool PERM = false;
    float* C; const float* bias; const float* res;
    __device__ __forceinline__ void operator()(const f32x4 (&acc)[2][2][4][2], const Unit& u, int wr, int wc, int fr, int fq) const {
        const int row0 = u.pm * BM + wr * 64 + fr, col0 = u.pn * BM + wc * 32 + 4 * fq;
        f32x4 bv[2][2];
#pragma unroll
        for (int bj = 0; bj < 2; ++bj)
#pragma unroll
            for (int n = 0; n < 2; ++n) bv[bj][n] = *(const f32x4*)(bias + col0 + bj * HALF + n * 16);
#pragma unroll
        for (int ai = 0; ai < 2; ++ai)
#pragma unroll
            for (int m = 0; m < 4; ++m) { const size_t off = (size_t)(row0 + ai * HALF + m * 16) * D + col0;
#pragma unroll
                for (int bj = 0; bj < 2; ++bj)
#pragma unroll
                    for (int n = 0; n < 2; ++n) { const f32x4 r = *(const f32x4*)(res + off + bj * HALF + n * 16);
                        *(f32x4*)(C + off + bj * HALF + n * 16) = acc[ai][bj][m][n] + bv[bj][n] + r * ALPHA; } }
    }
};
struct EpiSwiglu {
    static constexpr bool PERM = true;
    bf16_t* H; const float* bg; const float* bu;
    __device__ __forceinline__ void operator()(const f32x4 (&acc)[2][2][4][2], const Unit& u, int wr, int wc, int fr, int fq) const {
        const int row0 = u.pm * BM + wr * 64 + fr, col0 = u.pn * HALF + wc * 32 + 8 * fq;
        f32x4 gb[2], ub[2];
#pragma unroll
        for (int n = 0; n < 2; ++n) { gb[n] = *(const f32x4*)(bg + (size_t)u.e * D + col0 + 4 * n); ub[n] = *(const f32x4*)(bu + (size_t)u.e * D + col0 + 4 * n); }
#pragma unroll
        for (int ai = 0; ai < 2; ++ai)
#pragma unroll
            for (int m = 0; m < 4; ++m) {
                float o[8];
#pragma unroll
                for (int n = 0; n < 2; ++n) { const f32x4 g4 = acc[ai][0][m][n] + gb[n], u4 = acc[ai][1][m][n] + ub[n];
#pragma unroll
                    for (int j = 0; j < 4; ++j) { const float g = fminf(g4[j], 7.0f), uu = fminf(fmaxf(u4[j], -7.0f), 7.0f); o[4 * n + j] = (uu + 1.0f) * g * sigmoid_fast(1.702f * g); } }
                u32x4 w; w.x = cvt_pk_bf16(o[0], o[1]); w.y = cvt_pk_bf16(o[2], o[3]); w.z = cvt_pk_bf16(o[4], o[5]); w.w = cvt_pk_bf16(o[6], o[7]);
                *(u32x4*)(H + (size_t)(row0 + ai * HALF + m * 16) * D + col0) = w; }
    }
};

template <class Epi, class Sched>
__device__ __forceinline__ void gemm_phase(PG8_LAS unsigned char* lds, const int K, const Sched& S, const Epi& E) {
    int tid_ = threadIdx.x; asm volatile("" : "+v"(tid_));
    const int tid = tid_, wid = __builtin_amdgcn_readfirstlane(tid >> 6), lane = tid & 63, wr = wid >> 2, wc = wid & 3, fr = lane & 15, fq = lane >> 4;
    const int nt = K / BK;
    unsigned voffA[2], voffB[2];
#pragma unroll
    for (int i = 0; i < 2; ++i) { int R, C; stage_rc(tid * 16 + i * 8192, R, C); const int Rb = Epi::PERM ? ((R & ~31) + perm32(R & 31)) : R;
        voffA[i] = (unsigned)(R * K + C) * 2u; voffB[i] = (unsigned)(Rb * K + C) * 2u; }
    const size_t kstep = (size_t)(BK * 2);
    const size_t hstep = (size_t)HALF * K * 2;
    const unsigned ldsw = (unsigned)wid * 1024u;
    const int aoff = lds_byte(wr * 64 + fr, fq * 8), boff = lds_byte(wc * 32 + fr, fq * 8);
#define PG8_SA(b, h) (((b) * 2 + (h)) * HTB)
#define PG8_SB(b, h) ((4 + (b) * 2 + (h)) * HTB)
#define PG8_STAGE(bufoff, gbase, voff) do { _Pragma("unroll") for (int _i = 0; _i < 2; ++_i) \
        __builtin_amdgcn_global_load_lds((const unsigned*)((const char*)(gbase) + (voff)[_i]), (PG8_LAS unsigned*)(lds + (bufoff) + ldsw + _i * 8192), 16, 0, 0); } while (0)
#define PG8_LDA(dst, b, h) do { _Pragma("unroll") for (int m = 0; m < 4; ++m) _Pragma("unroll") for (int k = 0; k < 2; ++k) dst[m][k] = *(const PG8_LAS bf16x8*)(lds + PG8_SA(b, h) + aoff + m * 2048 + k * 1024); } while (0)
#define PG8_LDB(dst, b, h) do { _Pragma("unroll") for (int n = 0; n < 2; ++n) _Pragma("unroll") for (int k = 0; k < 2; ++k) dst[n][k] = *(const PG8_LAS bf16x8*)(lds + PG8_SB(b, h) + boff + n * 2048 + k * 1024); } while (0)
#define PG8_MMA(ai, bj, At, Bt) do { __builtin_amdgcn_s_setprio(1); _Pragma("unroll") for (int m = 0; m < 4; ++m) _Pragma("unroll") for (int n = 0; n < 2; ++n) _Pragma("unroll") for (int k = 0; k < 2; ++k) \
        acc[ai][bj][m][n] = __builtin_amdgcn_mfma_f32_16x16x32_bf16(Bt[n][k], At[m][k], acc[ai][bj][m][n], 0, 0, 0); __builtin_amdgcn_s_setprio(0); } while (0)
#define PG8_WAIT_V(n) asm volatile("s_waitcnt vmcnt(" #n ")" ::: "memory")
#define PG8_WAIT_L(n) asm volatile("s_waitcnt lgkmcnt(" #n ")" ::: "memory")
#define PG8_BAR __builtin_amdgcn_s_barrier()
#define PG8_SCHED __builtin_amdgcn_sched_barrier(0)
    Unit cur, nxt; int ui = 0;
    if (!S.next(0, cur)) return;
    f32x4 acc[2][2][4][2];
#pragma unroll
    for (int a = 0; a < 2; ++a)
#pragma unroll
        for (int b = 0; b < 2; ++b)
#pragma unroll
            for (int m = 0; m < 4; ++m)
#pragma unroll
                for (int n = 0; n < 2; ++n) acc[a][b][m][n] = (f32x4){0.f, 0.f, 0.f, 0.f};
    bf16x8 At[4][2], B0[2][2], B1[2][2];
    const char* cA = cur.a; const char* cB = cur.b;
    PG8_STAGE(PG8_SB(0, 0), cB, voffB); PG8_STAGE(PG8_SB(0, 1), cB + hstep, voffB); PG8_STAGE(PG8_SA(0, 0), cA, voffA); PG8_STAGE(PG8_SA(0, 1), cA + hstep, voffA);
    if (wr == 1) PG8_BAR;
    PG8_WAIT_V(2); PG8_BAR;
    PG8_STAGE(PG8_SB(1, 0), cB + kstep, voffB); PG8_STAGE(PG8_SA(1, 0), cA + kstep, voffA); PG8_STAGE(PG8_SB(1, 1), cB + hstep + kstep, voffB);
    PG8_WAIT_V(6); PG8_BAR;
    for (;;) {
        const bool has_next = S.next(ui + 1, nxt);
        const char* nA = has_next ? nxt.a : cA; const char* nB = has_next ? nxt.b : cB;
        for (int t = 0; t < nt; t += 2) {
            const bool last = (t == nt - 2);
            const char* a1 = cA + (size_t)(t + 1) * kstep;
            const char* a2 = last ? nA : cA + (size_t)(t + 2) * kstep; const char* b2 = last ? nB : cB + (size_t)(t + 2) * kstep;
            const char* a3 = a2 + kstep; const char* b3 = b2 + kstep;
            PG8_LDB(B0, 0, 0); PG8_LDB(B1, 0, 1); PG8_SCHED; PG8_LDA(At, 0, 0); PG8_STAGE(PG8_SA(1, 1), a1 + hstep, voffA);
            PG8_WAIT_V(8); PG8_WAIT_L(0); PG8_BAR; PG8_MMA(0, 0, At, B0); PG8_MMA(0, 1, At, B1); PG8_BAR; PG8_SCHED;
            PG8_LDA(At, 0, 1); PG8_STAGE(PG8_SB(0, 0), b2, voffB); PG8_STAGE(PG8_SB(0, 1), b2 + hstep, voffB); PG8_STAGE(PG8_SA(0, 0), a2, voffA);
            PG8_WAIT_V(8); PG8_WAIT_L(0); PG8_BAR; PG8_MMA(1, 0, At, B0); PG8_MMA(1, 1, At, B1); PG8_BAR; PG8_SCHED;
            PG8_LDB(B0, 1, 0); PG8_LDB(B1, 1, 1); PG8_SCHED; PG8_LDA(At, 1, 0); PG8_STAGE(PG8_SA(0, 1), a2 + hstep, voffA);
            PG8_WAIT_V(8); PG8_WAIT_L(0); PG8_BAR; PG8_MMA(0, 0, At, B0); PG8_MMA(0, 1, At, B1); PG8_BAR; PG8_SCHED;
            PG8_LDA(At, 1, 1); PG8_STAGE(PG8_SB(1, 0), b3, voffB); PG8_STAGE(PG8_SB(1, 1), b3 + hstep, voffB); PG8_STAGE(PG8_SA(1, 0), a3, voffA);
            PG8_WAIT_V(8); PG8_WAIT_L(0); PG8_BAR; PG8_MMA(1, 0, At, B0); PG8_MMA(1, 1, At, B1); PG8_BAR; PG8_SCHED;
        }
        if (wr == 0) PG8_BAR;
        E(acc, cur, wr, wc, fr, fq);
        if (!has_next) break;
#pragma unroll
        for (int a = 0; a < 2; ++a)
#pragma unroll
            for (int b = 0; b < 2; ++b)
#pragma unroll
                for (int m = 0; m < 4; ++m)
#pragma unroll
                    for (int n = 0; n < 2; ++n) acc[a][b][m][n] = (f32x4){0.f, 0.f, 0.f, 0.f};
        cur = nxt; cA = nA; cB = nB; ++ui;
        if (wr == 1) PG8_BAR;
    }
    PG8_WAIT_V(0);
    PG8_BAR;
#undef PG8_SA
#undef PG8_SB
#undef PG8_STAGE
#undef PG8_LDA
#undef PG8_LDB
#undef PG8_MMA
#undef PG8_WAIT_V
#undef PG8_WAIT_L
#undef PG8_BAR
#undef PG8_SCHED
}
}

struct Args { const float* in[26]; float* out; unsigned char* ws; int l_lo, l_hi, ph_lo, ph_hi, use_bar, pad; };
#define LP(i, stride) (args.in[i] + (size_t)l * (size_t)(stride))

struct RmId { __device__ __forceinline__ int operator()(int n) const { return n; } };
struct RmGU { int add; __device__ __forceinline__ int operator()(int n) const { return ((n >> 7) << 8) + add + (n & 127); } };
template <class RowMap>
__device__ __forceinline__ void cvt_block(const float* __restrict__ W, int N, int K, bf16_t* __restrict__ out, int kb, int nb, int lane, const RowMap& rm) {
    const int n0 = nb * 256 + lane * 4, k0 = kb * 64;
    const float* src = W + (size_t)k0 * N + n0;
#pragma unroll 2
    for (int j = 0; j < 8; ++j) {
        f32x4 r[8];
#pragma unroll
        for (int i = 0; i < 8; ++i) r[i] = __builtin_nontemporal_load((const f32x4*)(src + (size_t)(8 * j + i) * N));
#pragma unroll
        for (int c = 0; c < 4; ++c) {
            u32x4 w; w.x = cvt_pk_bf16(r[0][c], r[1][c]); w.y = cvt_pk_bf16(r[2][c], r[3][c]); w.z = cvt_pk_bf16(r[4][c], r[5][c]); w.w = cvt_pk_bf16(r[6][c], r[7][c]);
            *(u32x4*)(out + (size_t)rm(n0 + c) * K + k0 + 8 * j) = w;
        }
    }
}

__device__ __forceinline__ void ln_row16(float (&v)[2][8], const float* g, const float* b, int lane) {
    float s = 0.f;
#pragma unroll
    for (int j = 0; j < 2; ++j)
#pragma unroll
        for (int i = 0; i < 8; ++i) s += v[j][i];
    const float mean = wave_sum(s) * (1.f / D);
    float s2 = 0.f;
#pragma unroll
    for (int j = 0; j < 2; ++j)
#pragma unroll
        for (int i = 0; i < 8; ++i) { v[j][i] -= mean; s2 += v[j][i] * v[j][i]; }
    const float rstd = 1.0f / sqrtf(wave_sum(s2) * (1.f / D) + LN_EPS);
#pragma unroll
    for (int j = 0; j < 2; ++j) {
        const f32x4 g0 = *(const f32x4*)(g + 512 * j + 8 * lane), g1 = *(const f32x4*)(g + 512 * j + 8 * lane + 4);
        const f32x4 b0 = *(const f32x4*)(b + 512 * j + 8 * lane), b1 = *(const f32x4*)(b + 512 * j + 8 * lane + 4);
#pragma unroll
        for (int i = 0; i < 4; ++i) { v[j][i] = v[j][i] * rstd * g0[i] + b0[i]; v[j][4 + i] = v[j][4 + i] * rstd * g1[i] + b1[i]; }
    }
}

template <int PH>
__global__ void __launch_bounds__(NTHR, 2) fwd(Args args) {
    extern __shared__ __attribute__((aligned(16))) unsigned char lds_raw[];
    LAS unsigned char* ldsb = (LAS unsigned char*)lds_raw;
    float* lds = (float*)lds_raw;
    volatile LAS unsigned* xbw = (volatile LAS unsigned*)(ldsb + MISC_OFF + MISC_XB);
    LAS int* s_off = (LAS int*)(ldsb + MISC_OFF + MISC_OFFE);
    LAS int* s_nt = (LAS int*)(ldsb + MISC_OFF + MISC_NT);
    LAS unsigned char* s_tile_e = ldsb + MISC_OFF + MISC_TILEE;
    const int bid = blockIdx.x, nb = gridDim.x, NGW = nb * NWAVES;
#define PHASE_IDS() int tid = threadIdx.x; asm volatile("" : "+v"(tid)); const int lane = tid & 63, wave = __builtin_amdgcn_readfirstlane(tid >> 6), gw = bid * NWAVES + wave; (void)lane; (void)wave; (void)gw
    unsigned char* ws = args.ws;
    unsigned* ctl = (unsigned*)(ws + WS_CTL);
    int* tinfo = (int*)(ws + WS_TINFO);
    float* tprob = (float*)(ws + WS_TPROB);
    bf16_t* WinT = (bf16_t*)(ws + WS_WIN);
    bf16_t* WoutT = (bf16_t*)(ws + WS_WOUT);
    bf16_t* WpwT = (bf16_t*)(ws + WS_WPW);
    bf16_t* Wgu = (bf16_t*)(ws + WS_WGU);
    bf16_t* Wd = (bf16_t*)(ws + WS_WD);
    bf16_t* xb = (bf16_t*)(ws + WS_XB);
    bf16_t* z = (bf16_t*)(ws + WS_Z);
    bf16_t* hc = (bf16_t*)(ws + WS_HC);
    bf16_t* cat = (bf16_t*)(ws + WS_CAT);
    float* x1 = (float*)(ws + WS_X1);
    bf16_t* x1b = (bf16_t*)(ws + WS_X1B);
    float* xc = (float*)(ws + WS_XC);
    bf16_t* Xs = (bf16_t*)(ws + WS_XS);
    bf16_t* Yb = (bf16_t*)(ws + WS_XS);
    bf16_t* Hb = (bf16_t*)(ws + WS_H);

    if (threadIdx.x < 4) xbw[threadIdx.x] = 0u;
    __syncthreads();
    XcdBarrier bar; bar.bar = ctl + CW_BAR; bar.x = 0; bar.st = xbw;
    if (args.use_bar) bar = xcd_barrier_post(ctl + CW_BAR, xbw);
#define IN(k) ((PH) < 0 ? (args.ph_lo <= (k) && (k) < args.ph_hi) : ((PH) == (k)))
#define SEAM() do { if (args.use_bar) xcd_barrier(bar); } while (0)

    for (int l = args.l_lo; l < args.l_hi; ++l) {
        const float* xin = (l == 0) ? args.in[0] : xc;
        float* xout = (l == 1) ? args.out : xc;
        unsigned* cnt = ctl + CW_CNT + l * NE;

        if (IN(0)) {
            PHASE_IDS();
            const float* w_gate = LP(18, NE * D * D); const float* w_up = LP(20, NE * D * D); const float* w_down = LP(22, NE * D * D);
            for (int it = gw; it < 96 * 64; it += NGW) {
                const int m = it >> 6, r = it & 63, kb = r >> 2, nbk = r & 3, ty = m >> 5, e = m & 31;
                if (ty == 0) cvt_block(w_gate + (size_t)e * D * D, D, D, Wgu + (size_t)e * 2048 * D, kb, nbk, lane, RmGU{0});
                else if (ty == 1) cvt_block(w_up + (size_t)e * D * D, D, D, Wgu + (size_t)e * 2048 * D, kb, nbk, lane, RmGU{128});
                else cvt_block(w_down + (size_t)e * D * D, D, D, Wd + (size_t)e * D * D, kb, nbk, lane, RmId{});
            }
            const float* w_in = LP(1, D * DIN); const float* w_out = LP(12, D * D); const float* w_pw = LP(10, CW * CW);
            for (int it = gw; it < 144 + 64 + 4; it += NGW) {
                if (it < 144) cvt_block(w_in, DIN, D, WinT, it / 9, it % 9, lane, RmId{});
                else if (it < 208) cvt_block(w_out, D, D, WoutT, (it - 144) >> 2, (it - 144) & 3, lane, RmId{});
                else cvt_block(w_pw, CW, CW, WpwT, it - 208, 0, lane, RmId{});
            }
            if (l == 0) {
                for (int t = gw; t < NTOK; t += NGW) {
                    const float* xr = xin + (size_t)t * D;
#pragma unroll
                    for (int j = 0; j < 2; ++j) { const f32x4 a = *(const f32x4*)(xr + 512 * j + 8 * lane), b = *(const f32x4*)(xr + 512 * j + 8 * lane + 4);
                        u32x4 w; w.x = cvt_pk_bf16(a[0], a[1]); w.y = cvt_pk_bf16(a[2], a[3]); w.z = cvt_pk_bf16(b[0], b[1]); w.w = cvt_pk_bf16(b[2], b[3]);
                        *(u32x4*)(xb + (size_t)t * D + 512 * j + 8 * lane) = w; }
                }
            }
            SEAM();
        }
        if (IN(1)) {
            pg8::DenseOrder So; So.init(xb, WinT, NTOK, DIN, D, nb, bid);
            pg8::EpiBf16 E{z, DIN, LP(2, DIN), 0};
            pg8::gemm_phase(ldsb, D, So, E);
            SEAM();
        }
        if (IN(2)) {
            PHASE_IDS();
            const float* w_pool = LP(3, 4 * 64 * 64); const float* pool_scale = LP(4, 256); const float* rpb = LP(5, 8 * 15 * 31);
            for (int it = gw; it < NTOK * 4; it += NGW) {
                const int t = it >> 2, g = it & 3, b = t / S, s = t % S, hw = 1 << g;
                const int lo = max(s - hw, 0), hi = min(s + hw, S);
                float sum = 0.f;
                for (int j = lo; j < hi; ++j) sum += bf2f(z[(size_t)(b * S + j) * DIN + OFF_POOL + g * 64 + lane]);
                const float d = sum / (float)(hi - lo) - bf2f(z[(size_t)t * DIN + OFF_POOL + g * 64 + lane]);
                float o = 0.f;
                const float* wp = w_pool + (size_t)g * 64 * 64 + lane;
#pragma unroll 8
                for (int c = 0; c < 64; ++c) o = fmaf(__shfl(d, c), wp[c * 64], o);
                cat[(size_t)t * D + g * 64 + lane] = (bf16_t)(cvt_pk_bf16(o * pool_scale[g * 64 + lane], 0.f) & 0xffffu);
            }
            for (int it = gw; it < NTOK * 8; it += NGW) {
                const int t = it >> 3, h = it & 7, b = t / S, s = t % S, qr = s >> 6, qc = s & 63;
                const int sr = min(max(qr - 4, 0), 120), sc = min(max(qc - 8, 0), 48);
                float q[64];
                const bf16_t* qp = z + (size_t)t * DIN + OFF_Q + h * 64;
#pragma unroll
                for (int i = 0; i < 8; ++i) { const u32x4 w = *(const u32x4*)(qp + 8 * i); float f[8]; unpack8(w, f);
#pragma unroll
                    for (int jj = 0; jj < 8; ++jj) q[8 * i + jj] = f[jj]; }
                float sc2[2]; int kt[2];
#pragma unroll
                for (int u = 0; u < 2; ++u) {
                    const int j = lane + 64 * u, kr = sr + (j >> 4), kc = sc + (j & 15);
                    kt[u] = b * S + kr * 64 + kc;
                    const bf16_t* kp = z + (size_t)kt[u] * DIN + OFF_K + h * 64;
                    float a = 0.f;
#pragma unroll
                    for (int i = 0; i < 8; ++i) { const u32x4 w = *(const u32x4*)(kp + 8 * i); float f[8]; unpack8(w, f);
#pragma unroll
                        for (int jj = 0; jj < 8; ++jj) a = fmaf(q[8 * i + jj], f[jj], a); }
                    sc2[u] = a * 0.125f + rpb[(h * 15 + (kr - qr + 7)) * 31 + (kc - qc + 15)];
                }
                const float m = wave_max(fmaxf(sc2[0], sc2[1]));
                float p0 = expf(sc2[0] - m), p1 = expf(sc2[1] - m);
                const float inv = 1.0f / wave_sum(p0 + p1);
                p0 *= inv; p1 *= inv;
                float o = 0.f;
                const bf16_t* vp = z + OFF_V + h * 64 + lane;
#pragma unroll 4
                for (int j = 0; j < 64; ++j) { const int k0 = __shfl(kt[0], j); o = fmaf(__shfl(p0, j), bf2f(vp[(size_t)k0 * DIN]), o); }
#pragma unroll 4
                for (int j = 0; j < 64; ++j) { const int k1 = __shfl(kt[1], j); o = fmaf(__shfl(p1, j), bf2f(vp[(size_t)k1 * DIN]), o); }
                cat[(size_t)t * D + 256 + h * 64 + lane] = (bf16_t)(cvt_pk_bf16(o, 0.f) & 0xffffu);
            }
            {
                const float* conv_dw = LP(6, CONVK * CW); const float* conv_dw_b = LP(7, CW); const float* conv_ln_g = LP(8, CW); const float* conv_ln_b = LP(9, CW);
                float* hbuf = lds;
                float* cbuf = lds + 62 * 256;
                for (int tile = bid; tile < NTOK / 32; tile += nb) {
                    const int t0 = tile * 32, b = t0 / S, s0 = t0 % S;
                    __syncthreads();
                    for (int idx = tid; idx < 62 * 256; idx += NTHR) {
                        const int r = idx >> 8, c = idx & 255, s = s0 - 15 + r;
                        float v = 0.f;
                        if (s >= 0 && s < S) { const bf16_t* zp = z + (size_t)(b * S + s) * DIN; v = bf2f(zp[OFF_CA + c]) * sigmoidf_(bf2f(zp[OFF_CG + c])); }
                        hbuf[idx] = v;
                    }
                    __syncthreads();
                    {
                        const int c = tid & 255, half = tid >> 8;
                        float wv[CONVK];
#pragma unroll
                        for (int j = 0; j < CONVK; ++j) wv[j] = conv_dw[j * CW + c];
                        const float bb = conv_dw_b[c];
                        for (int i = half * 16; i < half * 16 + 16; ++i) {
                            float a = bb;
#pragma unroll
                            for (int j = 0; j < CONVK; ++j) a = fmaf(hbuf[(i + j) * 256 + c], wv[j], a);
                            cbuf[i * 256 + c] = a;
                        }
                    }
                    __syncthreads();
                    for (int i = wave; i < 32; i += NWAVES) {
                        f32x4 v = *(const f32x4*)&cbuf[i * 256 + lane * 4];
                        const float mean = wave_sum((v[0] + v[1]) + (v[2] + v[3])) * (1.f / 256.f);
                        v = v - mean;
                        const float rstd = 1.0f / sqrtf(wave_sum((v[0] * v[0] + v[1] * v[1]) + (v[2] * v[2] + v[3] * v[3])) * (1.f / 256.f) + LN_EPS);
                        const f32x4 gg = *(const f32x4*)(conv_ln_g + lane * 4), bb = *(const f32x4*)(conv_ln_b + lane * 4);
                        f32x4 y = v * rstd * gg + bb;
#pragma unroll
                        for (int jj = 0; jj < 4; ++jj) y[jj] *= sigmoidf_(y[jj]);
                        u32x2 w; w.x = cvt_pk_bf16(y[0], y[1]); w.y = cvt_pk_bf16(y[2], y[3]);
                        *(u32x2*)(hc + (size_t)(t0 + i) * CW + lane * 4) = w;
                    }
                }
                __syncthreads();
            }
            SEAM();
        }
        if (IN(3)) {
            pg8::DenseOrder So; So.init(hc, WpwT, NTOK, CW, CW, nb, bid);
            pg8::EpiBf16 E{cat + 768, D, LP(11, CW), 0};
            pg8::gemm_phase(ldsb, CW, So, E);
            SEAM();
        }
        if (IN(4)) {
            pg8::DenseOrder So; So.init(cat, WoutT, NTOK, D, D, nb, bid);
            pg8::EpiResF32 E{x1, LP(13, D), xin};
            pg8::gemm_phase(ldsb, D, So, E);
            SEAM();
        }
        if (IN(5)) {
            PHASE_IDS();
            const float* ln1_g = LP(14, D); const float* ln1_b = LP(15, D); const float* w_router = LP(16, D * NE); const float* b_router = LP(17, NE);
            for (int t = gw; t < NTOK; t += NGW) {
                float v[2][8];
                float* xr = x1 + (size_t)t * D;
#pragma unroll
                for (int j = 0; j < 2; ++j) { const f32x4 a = *(const f32x4*)(xr + 512 * j + 8 * lane), b = *(const f32x4*)(xr + 512 * j + 8 * lane + 4);
#pragma unroll
                    for (int i = 0; i < 4; ++i) { v[j][i] = a[i]; v[j][4 + i] = b[i]; } }
                ln_row16(v, ln1_g, ln1_b, lane);
#pragma unroll
                for (int j = 0; j < 2; ++j) {
                    *(f32x4*)(xr + 512 * j + 8 * lane) = (f32x4){v[j][0], v[j][1], v[j][2], v[j][3]};
                    *(f32x4*)(xr + 512 * j + 8 * lane + 4) = (f32x4){v[j][4], v[j][5], v[j][6], v[j][7]};
                    u32x4 w; w.x = cvt_pk_bf16(v[j][0], v[j][1]); w.y = cvt_pk_bf16(v[j][2], v[j][3]); w.z = cvt_pk_bf16(v[j][4], v[j][5]); w.w = cvt_pk_bf16(v[j][6], v[j][7]);
                    *(u32x4*)(x1b + (size_t)t * D + 512 * j + 8 * lane) = w;
                }
                float lg[NE];
#pragma unroll
                for (int e = 0; e < NE; ++e) lg[e] = 0.f;
#pragma unroll
                for (int j = 0; j < 2; ++j) {
#pragma unroll
                    for (int i = 0; i < 8; ++i) {
                        const float xv = v[j][i];
                        const float* wr = w_router + (size_t)(512 * j + 8 * lane + i) * NE;
#pragma unroll
                        for (int e4 = 0; e4 < 8; ++e4) { const f32x4 w4 = *(const f32x4*)(wr + 4 * e4);
                            lg[4 * e4 + 0] = fmaf(xv, w4[0], lg[4 * e4 + 0]); lg[4 * e4 + 1] = fmaf(xv, w4[1], lg[4 * e4 + 1]);
                            lg[4 * e4 + 2] = fmaf(xv, w4[2], lg[4 * e4 + 2]); lg[4 * e4 + 3] = fmaf(xv, w4[3], lg[4 * e4 + 3]); }
                        asm volatile("" ::: "memory");
                    }
                }
#pragma unroll
                for (int e = 0; e < NE; ++e) lg[e] = wave_sum(lg[e]) + b_router[e];
                unsigned taken = 0u; float tv[4]; int ti[4];
#pragma unroll
                for (int k = 0; k < 4; ++k) {
                    float best = -3.0e38f; int bi = 0;
#pragma unroll
                    for (int e = 0; e < NE; ++e) { const bool ok = !((taken >> e) & 1u) && (lg[e] > best); best = ok ? lg[e] : best; bi = ok ? e : bi; }
                    taken |= 1u << bi; tv[k] = best; ti[k] = bi;
                }
                const float e1 = expf(tv[1] - tv[0]), e2 = expf(tv[2] - tv[0]), e3 = expf(tv[3] - tv[0]);
                const float inv = 1.0f / (1.0f + e1 + e2 + e3);
                const float pr[4] = {inv, e1 * inv, e2 * inv, e3 * inv};
                if (lane == 0) {
#pragma unroll
                    for (int k = 0; k < 4; ++k) {
                        const unsigned pos = atomicAdd(&cnt[ti[k]], 1u);
                        tinfo[t * 4 + k] = (ti[k] << 16) | (int)pos;
                        tprob[t * 4 + k] = pr[k];
                    }
                }
            }
            SEAM();
        }
        if (IN(6) || IN(7) || IN(8) || IN(9)) {
            PHASE_IDS();
            __syncthreads();
            if (tid < 64) {
                const int c = (tid < NE) ? (int)__hip_atomic_load(&cnt[tid & 31], __ATOMIC_RELAXED, __HIP_MEMORY_SCOPE_AGENT) : 0;
                const int nt_e = (c + 255) >> 8;
                int incl = nt_e;
#pragma unroll
                for (int o = 1; o < 32; o <<= 1) { const int y = __shfl_up(incl, o); incl += (lane >= o) ? y : 0; }
                const int t0 = incl - nt_e;
                if (tid < NE) { s_off[tid] = t0 << 8;
#pragma unroll 1
                    for (int k = 0; k < nt_e; ++k) s_tile_e[t0 + k] = (unsigned char)tid; }
                if (tid == NE - 1) { s_off[NE] = incl << 8; s_nt[0] = incl; }
            }
            __syncthreads();
        }
        if (IN(6)) {
            PHASE_IDS();
            for (int it = gw; it < NTOK * 4; it += NGW) {
                const int ti = tinfo[it]; const int e = ti >> 16, pos = ti & 0xffff;
                const bf16_t* src = x1b + (size_t)(it >> 2) * D; bf16_t* dst = Xs + (size_t)(s_off[e] + pos) * D;
#pragma unroll
                for (int j = 0; j < 2; ++j) *(u32x4*)(dst + 512 * j + 8 * lane) = *(const u32x4*)(src + 512 * j + 8 * lane);
            }
            SEAM();
        }
        if (IN(7)) {
            pg8::MoeOrder So; So.ntiles = __builtin_amdgcn_readfirstlane(s_nt[0]); So.nPn = 8; So.G = nb; So.c = bid; So.A = (const char*)Xs; So.Bt = (const char*)Wgu; So.tstep = (size_t)256 * D * 2; So.estride = (size_t)2048 * D * 2; So.tile_e = s_tile_e;
            pg8::EpiSwiglu E{Hb, LP(19, NE * D), LP(21, NE * D)};
            pg8::gemm_phase(ldsb, D, So, E);
            SEAM();
        }
        if (IN(8)) {
            pg8::MoeOrder So; So.ntiles = __builtin_amdgcn_readfirstlane(s_nt[0]); So.nPn = 4; So.G = nb; So.c = bid; So.A = (const char*)Hb; So.Bt = (const char*)Wd; So.tstep = (size_t)256 * D * 2; So.estride = (size_t)D * D * 2; So.tile_e = s_tile_e;
            pg8::EpiBf16 E{Yb, D, LP(23, NE * D), (size_t)D};
            pg8::gemm_phase(ldsb, D, So, E);
            SEAM();
        }
        if (IN(9)) {
            PHASE_IDS();
            const float* ln2_g = LP(24, D); const float* ln2_b = LP(25, D);
            for (int t = gw; t < NTOK; t += NGW) {
                float v[2][8];
                const float* xr = x1 + (size_t)t * D;
#pragma unroll
                for (int j = 0; j < 2; ++j) { const f32x4 a = *(const f32x4*)(xr + 512 * j + 8 * lane), b = *(const f32x4*)(xr + 512 * j + 8 * lane + 4);
#pragma unroll
                    for (int i = 0; i < 4; ++i) { v[j][i] = a[i] * ALPHA; v[j][4 + i] = b[i] * ALPHA; } }
#pragma unroll
                for (int k = 0; k < 4; ++k) {
                    const int ti = tinfo[t * 4 + k]; const float p = tprob[t * 4 + k];
                    const int e = ti >> 16, pos = ti & 0xffff;
                    const bf16_t* yr = Yb + (size_t)(s_off[e] + pos) * D;
#pragma unroll
                    for (int j = 0; j < 2; ++j) { const u32x4 w = *(const u32x4*)(yr + 512 * j + 8 * lane); float f[8]; unpack8(w, f);
#pragma unroll
                        for (int i = 0; i < 8; ++i) v[j][i] = fmaf(p, f[i], v[j][i]); }
                }
                ln_row16(v, ln2_g, ln2_b, lane);
                float* orow = xout + (size_t)t * D;
#pragma unroll
                for (int j = 0; j < 2; ++j) {
                    *(f32x4*)(orow + 512 * j + 8 * lane) = (f32x4){v[j][0], v[j][1], v[j][2], v[j][3]};
                    *(f32x4*)(orow + 512 * j + 8 * lane + 4) = (f32x4){v[j][4], v[j][5], v[j][6], v[j][7]};
                    if (l == 0) { u32x4 w; w.x = cvt_pk_bf16(v[j][0], v[j][1]); w.y = cvt_pk_bf16(v[j][2], v[j][3]); w.z = cvt_pk_bf16(v[j][4], v[j][5]); w.w = cvt_pk_bf16(v[j][6], v[j][7]);
                        *(u32x4*)(xb + (size_t)t * D + 512 * j + 8 * lane) = w; }
                }
            }
            if (l + 1 < args.l_hi) SEAM();
        }
    }
#undef IN
#undef SEAM
}

constexpr int NPH = 10;
template <int PH> static bool set_attr() { return hipFuncSetAttribute((const void*)fwd<PH>, hipFuncAttributeMaxDynamicSharedMemorySize, LDS_BYTES) == hipSuccess; }
template <int PH> static void launch_ph(int grid, hipStream_t stream, const Args& a) { hipLaunchKernelGGL(fwd<PH>, dim3(grid), dim3(NTHR), LDS_BYTES, stream, a); }

extern "C" void kernel_launch(void* const* d_in, const int* in_sizes, int n_in, void* d_out, int out_size, void* d_ws, size_t ws_size, hipStream_t stream) {
    static int grid = 0;
    if (grid == 0) {
        if (n_in != 26 || out_size != NTOK * D || ws_size < WS_END) { fprintf(stderr, "kernel_launch: unexpected shapes n_in %d out %d ws %zu\n", n_in, out_size, ws_size); grid = -1; return; }
        int dev = 0, cus = 0;
        if (hipGetDevice(&dev) != hipSuccess || hipDeviceGetAttribute(&cus, hipDeviceAttributeMultiprocessorCount, dev) != hipSuccess) { grid = -1; return; }
        bool ok = true;
#if MK_SPLIT
        ok &= set_attr<0>(); ok &= set_attr<1>(); ok &= set_attr<2>(); ok &= set_attr<3>(); ok &= set_attr<4>(); ok &= set_attr<5>(); ok &= set_attr<6>(); ok &= set_attr<7>(); ok &= set_attr<8>(); ok &= set_attr<9>();
#else
        ok &= set_attr<-1>();
#endif
        if (!ok) { fprintf(stderr, "hipFuncSetAttribute failed\n"); grid = -1; return; }
        grid = cus;
    }
    if (grid < 0) return;
    (void)hipMemsetAsync((char*)d_ws + WS_CTL, 0, CTL_BYTES, stream);
    Args a{};
    for (int i = 0; i < 26; ++i) a.in[i] = (const float*)d_in[i];
    a.out = (float*)d_out; a.ws = (unsigned char*)d_ws;
#if MK_SPLIT
    for (int l = 0; l < 2; ++l) {
        a.l_lo = l; a.l_hi = l + 1; a.ph_lo = 0; a.ph_hi = NPH; a.use_bar = 0; a.pad = 0;
        launch_ph<0>(grid, stream, a); launch_ph<1>(grid, stream, a); launch_ph<2>(grid, stream, a); launch_ph<3>(grid, stream, a); launch_ph<4>(grid, stream, a);
        launch_ph<5>(grid, stream, a); launch_ph<6>(grid, stream, a); launch_ph<7>(grid, stream, a); launch_ph<8>(grid, stream, a); launch_ph<9>(grid, stream, a);
    }
#else
    a.l_lo = 0; a.l_hi = 2; a.ph_lo = 0; a.ph_hi = NPH; a.use_bar = 1; a.pad = 0;
    launch_ph<-1>(grid, stream, a);
#endif
}
```
